# Optimizing an MI355X kernel written in HIP

```python
import jax, jax.numpy as jnp
from jax import lax

D_MODEL = 1024
BATCH = 8
SEQ = 4096
DEPTH = 1

FOX_HEADS = 8
FOX_HEAD_DIM = 64
FOX_WIDTH = FOX_HEADS * FOX_HEAD_DIM
HGRN_HEADS = 4
HGRN_EXPAND = 128
HGRN_WIDTH = D_MODEL - FOX_WIDTH
HGRN_HEAD_V = HGRN_WIDTH // HGRN_HEADS
HGRN_KEY_WIDTH = HGRN_HEADS * HGRN_EXPAND
MIX_WIDTH = FOX_WIDTH + HGRN_WIDTH
IN_SPLITS = (FOX_WIDTH, FOX_WIDTH, FOX_WIDTH, FOX_HEADS,
             HGRN_KEY_WIDTH, HGRN_KEY_WIDTH, HGRN_WIDTH, HGRN_WIDTH)
IN_WIDTH = sum(IN_SPLITS)
Q_BLOCK = 128
HGRN_CHUNK = 64
PEER_HEADS = 8
PEER_NKEYS = 128
PEER_NEXPERTS = PEER_NKEYS * PEER_NKEYS
PEER_QDIM = 256
PEER_HALF = PEER_QDIM // 2
PEER_TOPK = 16
PEER_TOKEN_BLOCK = 128
FOX_FGATE_BIAS_INIT = 2.0
LN_EPS = 1e-5
RMS_EPS = 1e-6
DEEPNORM_ALPHA = (2 * DEPTH) ** 0.25
DEEPNORM_BETA = (8 * DEPTH) ** -0.25

kernel_name = "hybrid_fox_hgrn2_peer_deepnorm"

F32 = jnp.float32


def _layer_norm(x, g, b):
    xf = x.astype(F32)
    mu = jnp.mean(xf, axis=-1, keepdims=True)
    var = jnp.mean(jnp.square(xf - mu), axis=-1, keepdims=True)
    y = (xf - mu) * lax.rsqrt(var + LN_EPS) * g.astype(F32) + b.astype(F32)
    return y.astype(x.dtype)


def _head_rms_norm(x, g, out_dtype):
    xf = x.astype(F32)
    y = xf * lax.rsqrt(jnp.mean(jnp.square(xf), axis=-1, keepdims=True) + RMS_EPS) * g.astype(F32)
    return y.astype(out_dtype)


def _split_cols(proj):
    outs, start = [], 0
    for w in IN_SPLITS:
        outs.append(proj[..., start:start + w])
        start += w
    return outs


def _fox_attention(q, k, v, log_f):
    B, S, H, Dh = q.shape
    nb = S // Q_BLOCK
    c = jnp.cumsum(log_f, axis=1)
    cT = c.transpose(0, 2, 1)
    kf = k.astype(F32)
    scale = Dh ** -0.5
    qb = q.astype(F32).reshape(B, nb, Q_BLOCK, H, Dh).transpose(1, 0, 2, 3, 4)
    cb = c.reshape(B, nb, Q_BLOCK, H).transpose(1, 0, 2, 3)
    key_pos = jnp.arange(S)

    def block(args):
        i, q_i, c_i = args
        logits = jnp.einsum('bqhd,bkhd->bhqk', q_i, kf) * scale
        logits = logits + c_i.transpose(0, 2, 1)[..., None] - cT[:, :, None, :]
        q_pos = i * Q_BLOCK + jnp.arange(Q_BLOCK)
        mask = key_pos[None, :] <= q_pos[:, None]
        logits = jnp.where(mask, logits, -jnp.inf)
        p = jax.nn.softmax(logits, axis=-1)
        return jnp.einsum('bhqk,bkhd->bqhd', p.astype(v.dtype), v)

    out = lax.map(block, (jnp.arange(nb), qb, cb))
    return out.transpose(1, 0, 2, 3, 4).reshape(B, S, H, Dh)


def _hgrn2_recurrence(q, k, v, log_f):
    B, S, H, DK = q.shape
    DV = v.shape[-1]
    C = HGRN_CHUNK
    n = S // C

    def to_chunks(t):
        return t.reshape(B, n, C, H, t.shape[-1]).transpose(1, 0, 3, 2, 4)

    qc, kc, vc, gc = to_chunks(q), to_chunks(k), to_chunks(v), to_chunks(log_f)
    causal = jnp.tril(jnp.ones((C, C), dtype=bool))

    def step(state, inp):
        q_i, k_i, v_i, g_i = inp
        b = jnp.cumsum(g_i, axis=2)
        o_inter = jnp.einsum('bhtk,bhkv->bhtv', q_i * jnp.exp(b), state)
        diff = b[:, :, :, None, :] - b[:, :, None, :, :]
        decay = jnp.exp(jnp.where(causal[:, :, None], diff, -jnp.inf))
        scores = jnp.einsum('bhtk,bhtsk,bhsk->bhts', q_i, decay, k_i)
        o = o_inter + jnp.einsum('bhts,bhsv->bhtv', scores, v_i)
        b_last = b[:, :, -1:, :]
        k_dec = k_i * jnp.exp(b_last - b)
        new_state = jnp.exp(b_last[:, :, 0, :])[..., None] * state + jnp.einsum('bhsk,bhsv->bhkv', k_dec, v_i)
        return new_state, o

    s0 = jnp.zeros((B, H, DK, DV), F32)
    _, o = lax.scan(step, s0, (qc, kc, vc, gc))
    return o.transpose(1, 0, 3, 2, 4).reshape(B, S, H, DV)


def _hybrid_mixer(x, w_in, fox_fgate_b, hgrn_fgate_b, lb, fox_out_g, hgrn_out_g, w_out):
    B, S, _ = x.shape
    proj = x @ w_in
    fq, fk, fv, ff, hq, hf, hi, hg = _split_cols(proj)
    fq = fq.reshape(B, S, FOX_HEADS, FOX_HEAD_DIM)
    fk = fk.reshape(B, S, FOX_HEADS, FOX_HEAD_DIM)
    fv = fv.reshape(B, S, FOX_HEADS, FOX_HEAD_DIM)
    fox_log_f = jax.nn.log_sigmoid((ff + fox_fgate_b).astype(F32))
    fox_o = _fox_attention(fq, fk, fv, fox_log_f)
    fox_o = _head_rms_norm(fox_o, fox_out_g.reshape(FOX_HEADS, FOX_HEAD_DIM), x.dtype)
    lb = lb.reshape(HGRN_HEADS, HGRN_EXPAND)
    z = (hf + hgrn_fgate_b).astype(F32).reshape(B, S, HGRN_HEADS, HGRN_EXPAND)
    h_log_f = jnp.logaddexp(jnp.log(lb), jnp.log1p(-lb) + jax.nn.log_sigmoid(z))
    h_k = -jnp.expm1(h_log_f)
    h_q = hq.astype(F32).reshape(B, S, HGRN_HEADS, HGRN_EXPAND)
    h_v = hi.astype(F32).reshape(B, S, HGRN_HEADS, HGRN_HEAD_V)
    h_o = _hgrn2_recurrence(h_q, h_k, h_v, h_log_f)
    h_gate = jax.nn.silu(hg.astype(F32).reshape(B, S, HGRN_HEADS, HGRN_HEAD_V))
    h_o = (_head_rms_norm(h_o, hgrn_out_g.reshape(HGRN_HEADS, HGRN_HEAD_V), F32) * h_gate).astype(x.dtype)
    mixed = jnp.concatenate([fox_o.reshape(B, S, FOX_WIDTH), h_o.reshape(B, S, HGRN_WIDTH)], axis=-1)
    return mixed @ w_out


def _peer_ffn(x, w_q, sub_keys, u_tab, v_tab):
    B, S, D = x.shape
    T = B * S
    xt = x.reshape(T, D)
    q = (xt @ w_q).astype(F32).reshape(T, PEER_HEADS, 2, PEER_HALF)
    s = jnp.einsum('thpd,hpnd->thpn', q, sub_keys.astype(F32))
    s_top, i_top = lax.top_k(s, PEER_TOPK)
    cand = s_top[:, :, 0, :, None] + s_top[:, :, 1, None, :]
    cand_idx = i_top[:, :, 0, :, None] * PEER_NKEYS + i_top[:, :, 1, None, :]
    cand = cand.reshape(T, PEER_HEADS, PEER_TOPK * PEER_TOPK)
    cand_idx = cand_idx.reshape(T, PEER_HEADS, PEER_TOPK * PEER_TOPK)
    best, pos = lax.top_k(cand, PEER_TOPK)
    idx = jnp.take_along_axis(cand_idx, pos, axis=-1)
    gates = jax.nn.softmax(best, axis=-1)
    E = PEER_HEADS * PEER_TOPK
    nblk = T // PEER_TOKEN_BLOCK

    def blk(args):
        x_b, idx_b, g_b = args
        u = u_tab[idx_b]
        h = jax.nn.gelu(jnp.einsum('td,ted->te', x_b, u), approximate=False) * g_b
        return jnp.einsum('te,ted->td', h, v_tab[idx_b])

    y = lax.map(blk, (xt.reshape(nblk, PEER_TOKEN_BLOCK, D),
                      idx.reshape(nblk, PEER_TOKEN_BLOCK, E),
                      gates.astype(x.dtype).reshape(nblk, PEER_TOKEN_BLOCK, E)))
    return y.reshape(B, S, D)


def setup_inputs(seed: int = 0) -> dict:
    key = jax.random.key(seed)
    ks = jax.random.split(key, 20)
    L = DEPTH
    nrm = jax.random.normal
    col_scale = jnp.concatenate([
        jnp.ones((2 * FOX_WIDTH,), F32),
        jnp.full((FOX_WIDTH,), DEEPNORM_BETA, F32),
        jnp.ones((FOX_HEADS + 2 * HGRN_KEY_WIDTH,), F32),
        jnp.full((HGRN_WIDTH,), DEEPNORM_BETA, F32),
        jnp.ones((HGRN_WIDTH,), F32)])
    return {
        "x": nrm(ks[0], (BATCH, SEQ, D_MODEL), F32),
        "ln_in_g": 1.0 + 0.02 * nrm(ks[1], (D_MODEL,), F32),
        "ln_in_b": 0.02 * nrm(ks[2], (D_MODEL,), F32),
        "w_in": nrm(ks[3], (L, D_MODEL, IN_WIDTH), F32) * (D_MODEL ** -0.5) * col_scale,
        "fox_fgate_b": FOX_FGATE_BIAS_INIT + 0.1 * nrm(ks[4], (L, FOX_HEADS), F32),
        "hgrn_fgate_b": 0.02 * nrm(ks[5], (L, HGRN_KEY_WIDTH), F32),
        "hgrn_lb_logits": 0.1 * nrm(ks[6], (DEPTH + 1, HGRN_KEY_WIDTH), F32),
        "fox_out_g": 1.0 + 0.02 * nrm(ks[7], (L, FOX_WIDTH), F32),
        "hgrn_out_g": 1.0 + 0.02 * nrm(ks[8], (L, HGRN_WIDTH), F32),
        "w_out": nrm(ks[9], (L, MIX_WIDTH, D_MODEL), F32) * (MIX_WIDTH ** -0.5) * DEEPNORM_BETA,
        "ln_mix_g": 1.0 + 0.02 * nrm(ks[10], (L, D_MODEL), F32),
        "ln_mix_b": 0.02 * nrm(ks[11], (L, D_MODEL), F32),
        "peer_w_q": nrm(ks[12], (L, D_MODEL, PEER_HEADS * PEER_QDIM), F32) * (D_MODEL ** -0.5),
        "peer_sub_keys": nrm(ks[13], (L, PEER_HEADS, 2, PEER_NKEYS, PEER_HALF), F32) * (PEER_HALF ** -0.5),
        "peer_u": nrm(ks[14], (L, PEER_NEXPERTS, D_MODEL), F32) * (D_MODEL ** -0.5) * DEEPNORM_BETA,
        "peer_v": nrm(ks[15], (L, PEER_NEXPERTS, D_MODEL), F32) * DEEPNORM_BETA,
        "ln_ffn_g": 1.0 + 0.02 * nrm(ks[16], (L, D_MODEL), F32),
        "ln_ffn_b": 0.02 * nrm(ks[17], (L, D_MODEL), F32),
    }


def reference(x, ln_in_g, ln_in_b, w_in, fox_fgate_b, hgrn_fgate_b, hgrn_lb_logits,
              fox_out_g, hgrn_out_g, w_out, ln_mix_g, ln_mix_b, peer_w_q, peer_sub_keys,
              peer_u, peer_v, ln_ffn_g, ln_ffn_b):
    x = _layer_norm(x, ln_in_g, ln_in_b)
    lb_all = jnp.cumsum(jax.nn.softmax(hgrn_lb_logits.astype(F32), axis=0), axis=0)
    for l in range(DEPTH):
        mix = _hybrid_mixer(x, w_in[l], fox_fgate_b[l], hgrn_fgate_b[l], lb_all[l],
                            fox_out_g[l], hgrn_out_g[l], w_out[l])
        x = _layer_norm(DEEPNORM_ALPHA * x + mix, ln_mix_g[l], ln_mix_b[l])
        ffn = _peer_ffn(x, peer_w_q[l], peer_sub_keys[l], peer_u[l], peer_v[l])
        x = _layer_norm(DEEPNORM_ALPHA * x + ffn, ln_ffn_g[l], ln_ffn_b[l])
    return x
```

```cpp
#include <hip/hip_runtime.h>
#include <cstdio>
#include <cstdint>

constexpr int D_MODEL = 1024, BATCH = 8, SEQ = 4096, M = BATCH * SEQ;
constexpr int FOX_H = 8, FOX_D = 64, FOX_W = 512;
constexpr int HG_H = 4, HG_DK = 128, HG_DV = 128, HG_W = 512;
constexpr int IN_W = 3592, NPROJ = 3584;
constexpr int PH = 8, PNK = 128, PQD = 256, PHALF = 128, PTOPK = 16, PQW = PH * PQD;
constexpr int NEXP = PNK * PNK;
constexpr float LN_EPS = 1e-5f, RMS_EPS = 1e-6f;
constexpr float ALPHA = 1.189207115002721f;
constexpr float LOG2E = 1.4426950408889634f;
constexpr float C2 = 0.125f * LOG2E;
constexpr int C_FQ = 0, C_FK = 512, C_FV = 1024, C_HQ = 1536, C_HZ = 2048, C_HV = 2560, C_HGT = 3072;

typedef unsigned short bf16;
__host__ __device__ __forceinline__ float bf2f(bf16 v) { return __builtin_bit_cast(float, (unsigned)v << 16); }
__device__ __forceinline__ bf16 f2bf(float f) { unsigned u = __builtin_bit_cast(unsigned, f); return (bf16)((u + 0x7fffu + ((u >> 16) & 1u)) >> 16); }

constexpr size_t MiB = 1u << 20;
constexpr size_t WS_CTL = 0;
constexpr size_t WS_WIN = 1 * MiB;
constexpr size_t WS_WOUT = 8 * MiB;
constexpr size_t WS_WQ = 10 * MiB;
constexpr size_t WS_KEYS = 14 * MiB;
constexpr size_t WS_FLOG = 15 * MiB;
constexpr size_t WS_CUM = 16 * MiB;
constexpr size_t WS_LB = 17 * MiB;
constexpr size_t WS_UT = 32 * MiB;
constexpr size_t WS_VT = 64 * MiB;
constexpr size_t WS_XN = 96 * MiB;
constexpr size_t WS_PROJ = 160 * MiB;
constexpr size_t WS_MIXED = 384 * MiB;
constexpr size_t WS_PSEL = 448 * MiB;
constexpr size_t WS_END = 512 * MiB;
constexpr size_t DO_Y = 0;

__device__ __forceinline__ float block_sum256(float v, float* red) {
    for (int o = 32; o > 0; o >>= 1) v += __shfl_xor(v, o);
    const int w = threadIdx.x >> 6;
    __syncthreads();
    if ((threadIdx.x & 63) == 0) red[w] = v;
    __syncthreads();
    return red[0] + red[1] + red[2] + red[3];
}
__device__ __forceinline__ float log_sigmoid(float x) { return fminf(x, 0.f) - log1pf(expf(-fabsf(x))); }

__global__ void k_conv_win(const float* w_in, bf16* WT) {
    const size_t i = (size_t)blockIdx.x * 256 + threadIdx.x; if (i >= (size_t)NPROJ * 1024) return;
    const int n = i / 1024, k = i % 1024; const int src = n < 1536 ? n : n + 8;
    WT[i] = f2bf(w_in[(size_t)k * IN_W + src]);
}
__global__ void k_conv_t(const float* W, bf16* WT, int K, int N) {
    const size_t i = (size_t)blockIdx.x * 256 + threadIdx.x; if (i >= (size_t)N * K) return;
    const int n = i / K, k = i % K; WT[i] = f2bf(W[(size_t)k * N + n]);
}
__global__ void k_conv(const float* W, bf16* O, size_t n) { const size_t i = (size_t)blockIdx.x * 256 + threadIdx.x; if (i < n) O[i] = f2bf(W[i]); }
__global__ void k_lb(const float* lbl, float* lb) { const int j = blockIdx.x * 256 + threadIdx.x; if (j < 512) { const float a = lbl[j], b = lbl[512 + j]; lb[j] = 1.f / (1.f + expf(b - a)); } }

__global__ void k_ln_in(const float* x, const float* g, const float* b, const float* w_in, const float* fb, bf16* XN, float* FLOG) {
    __shared__ float red[4];
    const int row = blockIdx.x, t = threadIdx.x; const float* xr = x + (size_t)row * 1024;
    float v[4]; float s = 0.f;
    for (int j = 0; j < 4; ++j) { v[j] = xr[t + 256 * j]; s += v[j]; }
    const float mean = block_sum256(s, red) * (1.f / 1024.f); float s2 = 0.f;
    for (int j = 0; j < 4; ++j) { v[j] -= mean; s2 += v[j] * v[j]; }
    const float rstd = rsqrtf(block_sum256(s2, red) * (1.f / 1024.f) + LN_EPS);
    float y[4];
    for (int j = 0; j < 4; ++j) { const int c = t + 256 * j; y[j] = v[j] * rstd * g[c] + b[c]; XN[(size_t)row * 1024 + c] = f2bf(y[j]); }
    for (int h = 0; h < 8; ++h) {
        float d = 0.f;
        for (int j = 0; j < 4; ++j) d += y[j] * w_in[(size_t)(t + 256 * j) * IN_W + 1536 + h];
        d = block_sum256(d, red);
        if (t == 0) FLOG[(size_t)row * 8 + h] = log_sigmoid(d + fb[h]);
    }
}
__global__ void k_cumsum(const float* FLOG, float* CUM) {
    const int bh = blockIdx.x, b = bh / 8, h = bh % 8, lane = threadIdx.x;
    float s = 0.f;
    for (int i = 0; i < 64; ++i) s += FLOG[((size_t)b * SEQ + lane * 64 + i) * 8 + h];
    float inc = s;
    for (int o = 1; o < 64; o <<= 1) { const float t = __shfl_up(inc, o); if (lane >= o) inc += t; }
    float run = inc - s;
    for (int i = 0; i < 64; ++i) { run += FLOG[((size_t)b * SEQ + lane * 64 + i) * 8 + h]; CUM[(size_t)bh * SEQ + lane * 64 + i] = run * LOG2E; }
}

template <class Epi> __global__ void __launch_bounds__(256) k_gemm(const bf16* A, int lda, const bf16* Bt, int Mm, int Nn, int K, Epi epi) {
    __shared__ float As[16][68], Bs[16][68];
    const int t = threadIdx.x, tx = t & 15, ty = t >> 4, m0 = blockIdx.y * 64, n0 = blockIdx.x * 64;
    float acc[4][4] = {};
    for (int k0 = 0; k0 < K; k0 += 16) {
        for (int i = 0; i < 4; ++i) { const int e = t + 256 * i, r = e >> 4, kk = e & 15;
            As[kk][r] = bf2f(A[(size_t)(m0 + r) * lda + k0 + kk]); Bs[kk][r] = bf2f(Bt[(size_t)(n0 + r) * K + k0 + kk]); }
        __syncthreads();
#pragma unroll
        for (int kk = 0; kk < 16; ++kk) { float a[4], b[4];
#pragma unroll
            for (int i = 0; i < 4; ++i) { a[i] = As[kk][ty * 4 + i]; b[i] = Bs[kk][tx * 4 + i]; }
#pragma unroll
            for (int i = 0; i < 4; ++i)
#pragma unroll
                for (int j = 0; j < 4; ++j) acc[i][j] += a[i] * b[j]; }
        __syncthreads();
    }
    for (int i = 0; i < 4; ++i) for (int j = 0; j < 4; ++j) epi(m0 + ty * 4 + i, n0 + tx * 4 + j, acc[i][j]);
}
struct EpiProj { bf16* P; const float* hzb;
    __device__ void operator()(int m, int n, float v) const {
        if (n < 512) v *= C2; else if (n >= C_HZ && n < C_HV) v += hzb[n - C_HZ]; else if (n >= C_HGT) v = v / (1.f + expf(-v));
        P[(size_t)m * NPROJ + n] = f2bf(v); } };
struct EpiY { const bf16* XN; float* Y; __device__ void operator()(int m, int n, float v) const { Y[(size_t)m * 1024 + n] = ALPHA * bf2f(XN[(size_t)m * 1024 + n]) + v; } };
struct EpiQP { bf16* Q; __device__ void operator()(int m, int n, float v) const { Q[(size_t)m * PQW + n] = f2bf(v); } };

__global__ void k_ln_rows(const float* Y, const float* g, const float* b, bf16* X1) {
    __shared__ float red[4];
    const int row = blockIdx.x, t = threadIdx.x; const float* xr = Y + (size_t)row * 1024;
    float v[4]; float s = 0.f;
    for (int j = 0; j < 4; ++j) { v[j] = xr[t + 256 * j]; s += v[j]; }
    const float mean = block_sum256(s, red) * (1.f / 1024.f); float s2 = 0.f;
    for (int j = 0; j < 4; ++j) { v[j] -= mean; s2 += v[j] * v[j]; }
    const float rstd = rsqrtf(block_sum256(s2, red) * (1.f / 1024.f) + LN_EPS);
    for (int j = 0; j < 4; ++j) { const int c = t + 256 * j; X1[(size_t)row * 1024 + c] = f2bf(v[j] * rstd * g[c] + b[c]); }
}

__global__ void __launch_bounds__(256) k_fox_attn(const bf16* P, const float* CUM, const float* og, bf16* MIXED) {
    __shared__ float Ks[64][64], Vs[64][64], Cs[64];
    const int qb = blockIdx.x, h = blockIdx.y, b = blockIdx.z, t = threadIdx.x;
    const int qpos = qb * 256 + t; const size_t row = (size_t)b * SEQ + qpos;
    float q[64], o[64];
    for (int d = 0; d < 64; ++d) { q[d] = bf2f(P[row * NPROJ + C_FQ + h * 64 + d]); o[d] = 0.f; }
    const float cq = CUM[((size_t)b * 8 + h) * SEQ + qpos];
    float mx = -INFINITY, l = 0.f;
    const int ntile = (qb * 256 + 256) / 64;
    for (int kt = 0; kt < ntile; ++kt) {
        __syncthreads();
        for (int e = t; e < 64 * 64; e += 256) { const int r = e >> 6, d = e & 63; const size_t kr = (size_t)b * SEQ + kt * 64 + r;
            Ks[r][d] = bf2f(P[kr * NPROJ + C_FK + h * 64 + d]); Vs[r][d] = bf2f(P[kr * NPROJ + C_FV + h * 64 + d]); }
        if (t < 64) Cs[t] = CUM[((size_t)b * 8 + h) * SEQ + kt * 64 + t];
        __syncthreads();
        for (int r = 0; r < 64; ++r) {
            const int kpos = kt * 64 + r; if (kpos > qpos) break;
            float s = 0.f;
#pragma unroll
            for (int d = 0; d < 64; ++d) s += q[d] * Ks[r][d];
            s += cq - Cs[r];
            if (s > mx) { const float f = exp2f(mx - s); l *= f;
#pragma unroll
                for (int d = 0; d < 64; ++d) o[d] *= f; mx = s; }
            const float p = exp2f(s - mx); l += p;
#pragma unroll
            for (int d = 0; d < 64; ++d) o[d] += p * Vs[r][d];
        }
    }
    float ss = 0.f; const float il = 1.f / l;
    for (int d = 0; d < 64; ++d) { o[d] *= il; ss += o[d] * o[d]; }
    const float rs = rsqrtf(ss * (1.f / 64.f) + RMS_EPS);
    for (int d = 0; d < 64; ++d) MIXED[row * 1024 + h * 64 + d] = f2bf(o[d] * rs * og[h * 64 + d]);
}

__global__ void __launch_bounds__(128) k_hgrn(const bf16* P, const float* lb, const float* og, bf16* MIXED) {
    __shared__ float fs[128], ks[128], qs[128], red[2];
    const int h = blockIdx.x, b = blockIdx.y, t = threadIdx.x;
    float S[128];
    for (int k = 0; k < 128; ++k) S[k] = 0.f;
    const float lbv = lb[h * 128 + t], g = og[h * 128 + t];
    for (int s = 0; s < SEQ; ++s) {
        const size_t row = (size_t)b * SEQ + s; const bf16* pr = P + row * NPROJ;
        const float z = bf2f(pr[C_HZ + h * 128 + t]); const float sg = 1.f / (1.f + expf(-z));
        const float f = lbv + (1.f - lbv) * sg;
        __syncthreads();
        fs[t] = f; ks[t] = (1.f - lbv) * (1.f - sg); qs[t] = bf2f(pr[C_HQ + h * 128 + t]);
        __syncthreads();
        const float v = bf2f(pr[C_HV + h * 128 + t]); float o = 0.f;
#pragma unroll
        for (int k = 0; k < 128; ++k) { S[k] = fs[k] * S[k] + ks[k] * v; o += S[k] * qs[k]; }
        float ss = o * o;
        for (int w = 32; w > 0; w >>= 1) ss += __shfl_xor(ss, w);
        if ((t & 63) == 0) red[t >> 6] = ss;
        __syncthreads();
        const float rs = rsqrtf((red[0] + red[1]) * (1.f / 128.f) + RMS_EPS);
        MIXED[row * 1024 + 512 + h * 128 + t] = f2bf(o * rs * g * bf2f(pr[C_HGT + h * 128 + t]));
    }
}

__global__ void __launch_bounds__(256) k_peer_select(const bf16* QP, const bf16* KEYS, int* IDX, float* GATE) {
    __shared__ float qs[2048], sc[16][128], ts[16][16], cand[8][256], bsS[8][16]; __shared__ int ti[16][16], biS[8][16];
    const int tok = blockIdx.x, t = threadIdx.x;
    for (int i = t; i < 2048; i += 256) qs[i] = bf2f(QP[(size_t)tok * PQW + i]);
    __syncthreads();
    for (int i = t; i < 2048; i += 256) { const int hp = i >> 7, n = i & 127; const bf16* kr = KEYS + ((size_t)hp * 128 + n) * 128; float s = 0.f;
        for (int d = 0; d < 128; ++d) s += qs[hp * 128 + d] * bf2f(kr[d]); sc[hp][n] = s; }
    __syncthreads();
    if (t < 16) { for (int r = 0; r < 16; ++r) { float best = -INFINITY; int bi = 0; for (int n = 0; n < 128; ++n) { const float v = sc[t][n]; if (v > best) { best = v; bi = n; } } ts[t][r] = best; ti[t][r] = bi; sc[t][bi] = -INFINITY; } }
    __syncthreads();
    { const int hh = t >> 5; for (int c = t & 31; c < 256; c += 32) cand[hh][c] = ts[hh * 2][c >> 4] + ts[hh * 2 + 1][c & 15]; }
    __syncthreads();
    if (t < 8) { float mx = -INFINITY;
        for (int r = 0; r < 16; ++r) { float best = -INFINITY; int bc = 0; for (int c = 0; c < 256; ++c) { const float v = cand[t][c]; if (v > best) { best = v; bc = c; } } bsS[t][r] = best; biS[t][r] = ti[t * 2][bc >> 4] * 128 + ti[t * 2 + 1][bc & 15]; cand[t][bc] = -INFINITY; mx = fmaxf(mx, best); }
        float sum = 0.f; for (int r = 0; r < 16; ++r) { const float e = expf(bsS[t][r] - mx); bsS[t][r] = e; sum += e; }
        for (int r = 0; r < 16; ++r) { IDX[(size_t)tok * 128 + t * 16 + r] = biS[t][r]; GATE[(size_t)tok * 128 + t * 16 + r] = bsS[t][r] / sum; } }
}
__global__ void __launch_bounds__(256) k_peer_expert(const bf16* X1, const int* IDX, const float* GATE, const bf16* UT, const bf16* VT, const float* g, const float* bb, float* out) {
    __shared__ float xs[1024], hs[128], red[4]; __shared__ int is[128];
    const int tok = blockIdx.x, t = threadIdx.x, lane = t & 63, w = t >> 6;
    for (int i = t; i < 1024; i += 256) xs[i] = bf2f(X1[(size_t)tok * 1024 + i]);
    if (t < 128) is[t] = IDX[(size_t)tok * 128 + t];
    __syncthreads();
    for (int e = w; e < 128; e += 4) { const bf16* ur = UT + (size_t)is[e] * 1024; float s = 0.f;
        for (int d = lane; d < 1024; d += 64) s += xs[d] * bf2f(ur[d]);
        for (int o = 32; o > 0; o >>= 1) s += __shfl_xor(s, o);
        if (lane == 0) hs[e] = 0.5f * s * (1.f + erff(s * 0.7071067811865476f)) * GATE[(size_t)tok * 128 + e]; }
    __syncthreads();
    float y[4] = {0.f, 0.f, 0.f, 0.f};
    for (int e = 0; e < 128; ++e) { const bf16* vr = VT + (size_t)is[e] * 1024; const float hh = hs[e];
        for (int j = 0; j < 4; ++j) y[j] += hh * bf2f(vr[t + 256 * j]); }
    float s = 0.f;
    for (int j = 0; j < 4; ++j) { y[j] += ALPHA * xs[t + 256 * j]; s += y[j]; }
    const float mean = block_sum256(s, red) * (1.f / 1024.f); float s2 = 0.f;
    for (int j = 0; j < 4; ++j) { y[j] -= mean; s2 += y[j] * y[j]; }
    const float rstd = rsqrtf(block_sum256(s2, red) * (1.f / 1024.f) + LN_EPS);
    for (int j = 0; j < 4; ++j) { const int c = t + 256 * j; out[(size_t)tok * 1024 + c] = y[j] * rstd * g[c] + bb[c]; }
}

extern "C" void kernel_launch(void* const* d_in, const int* in_sizes, int n_in, void* d_out, int out_size, void* d_ws, size_t ws_size, hipStream_t stream) {
    if (n_in != 18 || ws_size < WS_END) { fprintf(stderr, "kernel_launch: unexpected n_in %d / ws %zu\n", n_in, ws_size); return; }
    const float* x = (const float*)d_in[0]; const float* ln_in_g = (const float*)d_in[1]; const float* ln_in_b = (const float*)d_in[2];
    const float* w_in = (const float*)d_in[3]; const float* fox_fb = (const float*)d_in[4]; const float* hg_fb = (const float*)d_in[5];
    const float* lb_logits = (const float*)d_in[6]; const float* fox_og = (const float*)d_in[7]; const float* hg_og = (const float*)d_in[8];
    const float* w_out = (const float*)d_in[9]; const float* ln_mix_g = (const float*)d_in[10]; const float* ln_mix_b = (const float*)d_in[11];
    const float* w_q = (const float*)d_in[12]; const float* sub_keys = (const float*)d_in[13]; const float* pu = (const float*)d_in[14];
    const float* pv = (const float*)d_in[15]; const float* ln_ffn_g = (const float*)d_in[16]; const float* ln_ffn_b = (const float*)d_in[17];
    unsigned char* ws = (unsigned char*)d_ws; float* out = (float*)d_out;
    bf16* WIN = (bf16*)(ws + WS_WIN); bf16* WOUT = (bf16*)(ws + WS_WOUT); bf16* WQ = (bf16*)(ws + WS_WQ); bf16* KEYS = (bf16*)(ws + WS_KEYS);
    float* FLOG = (float*)(ws + WS_FLOG); float* CUM = (float*)(ws + WS_CUM); float* LB = (float*)(ws + WS_LB);
    bf16* UT = (bf16*)(ws + WS_UT); bf16* VT = (bf16*)(ws + WS_VT); bf16* XN = (bf16*)(ws + WS_XN); bf16* PROJ = (bf16*)(ws + WS_PROJ);
    bf16* MIXED = (bf16*)(ws + WS_MIXED); bf16* QP = (bf16*)(ws + WS_PROJ); int* IDX = (int*)(ws + WS_PSEL); float* GATE = (float*)(ws + WS_PSEL + 16 * MiB);
    float* Y = out;
    k_conv_win<<<(NPROJ * 1024 + 255) / 256, 256, 0, stream>>>(w_in, WIN);
    k_conv_t<<<(1024 * 1024 + 255) / 256, 256, 0, stream>>>(w_out, WOUT, 1024, 1024);
    k_conv_t<<<(2048 * 1024 + 255) / 256, 256, 0, stream>>>(w_q, WQ, 1024, 2048);
    k_conv<<<(16 * 128 * 128 + 255) / 256, 256, 0, stream>>>(sub_keys, KEYS, (size_t)16 * 128 * 128);
    k_conv<<<(NEXP * 1024 + 255) / 256, 256, 0, stream>>>(pu, UT, (size_t)NEXP * 1024);
    k_conv<<<(NEXP * 1024 + 255) / 256, 256, 0, stream>>>(pv, VT, (size_t)NEXP * 1024);
    k_lb<<<2, 256, 0, stream>>>(lb_logits, LB);
    k_ln_in<<<M, 256, 0, stream>>>(x, ln_in_g, ln_in_b, w_in, fox_fb, XN, FLOG);
    k_cumsum<<<64, 64, 0, stream>>>(FLOG, CUM);
    k_gemm<EpiProj><<<dim3(NPROJ / 64, M / 64), 256, 0, stream>>>(XN, 1024, WIN, M, NPROJ, 1024, EpiProj{PROJ, hg_fb});
    k_fox_attn<<<dim3(SEQ / 256, 8, BATCH), 256, 0, stream>>>(PROJ, CUM, fox_og, MIXED);
    k_hgrn<<<dim3(4, BATCH), 128, 0, stream>>>(PROJ, LB, hg_og, MIXED);
    k_gemm<EpiY><<<dim3(1024 / 64, M / 64), 256, 0, stream>>>(MIXED, 1024, WOUT, M, 1024, 1024, EpiY{XN, Y});
    k_ln_rows<<<M, 256, 0, stream>>>(Y, ln_mix_g, ln_mix_b, XN);
    k_gemm<EpiQP><<<dim3(PQW / 64, M / 64), 256, 0, stream>>>(XN, 1024, WQ, M, PQW, 1024, EpiQP{QP});
    k_peer_select<<<M, 256, 0, stream>>>(QP, KEYS, IDX, GATE);
    k_peer_expert<<<M, 256, 0, stream>>>(XN, IDX, GATE, UT, VT, ln_ffn_g, ln_ffn_b, out);
}
```
